# Optimizing an MI355X kernel written in HIP

```python
import jax
import jax.numpy as jnp
from jax import lax
import numpy as np

D_MODEL = 2048
BATCH = 1
SEQ = 16384
DEPTH = 2

GRID_W = 64
CTX_LEN = 256

CONV_W = D_MODEL // 4
ATT_HEAD_DIM = 64
ATT_HEADS = (3 * D_MODEL // 8) // ATT_HEAD_DIM
ATT_KV_HEADS = 4
ATT_W = ATT_HEADS * ATT_HEAD_DIM
RWKV_HEAD_DIM = 64
RWKV_HEADS = (3 * D_MODEL // 8) // RWKV_HEAD_DIM
RWKV_W = RWKV_HEADS * RWKV_HEAD_DIM
MIX_W = CONV_W + ATT_W + RWKV_W

CONV_K = 3
WINDOW = 128
ATT_BLOCK = 128
ROPE_THETA = 10000.0
ROPE_FREQS = ATT_HEAD_DIM // 4
DECAY_RANK = 64
ICLR_RANK = 64
GATE_RANK = 128
RWKV_GN_EPS = 64e-5

N_EXPERTS = 32
N_EXPERT_GROUPS = 4
EXPERTS_PER_GROUP = N_EXPERTS // N_EXPERT_GROUPS
TOP_K = 2
D_EXPERT = 768
MOE_BLOCK = 128

RMS_EPS = 1e-6
NEG_INF = -1e30

IN_SPLITS = (CONV_W, CONV_W, CONV_W,
             ATT_HEADS * ATT_HEAD_DIM, ATT_KV_HEADS * ATT_HEAD_DIM, ATT_KV_HEADS * ATT_HEAD_DIM,
             RWKV_W, RWKV_W, RWKV_W,
             DECAY_RANK, DECAY_RANK, ICLR_RANK, ICLR_RANK, GATE_RANK)
IN_W = sum(IN_SPLITS)

kernel_name = "hybrid_conv_swa_rwkv7_moe_dit"


def _rms_norm(x, g):
    x32 = x.astype(jnp.float32)
    y = x32 * lax.rsqrt(jnp.mean(x32 * x32, axis=-1, keepdims=True) + RMS_EPS)
    return (y * g.astype(jnp.float32)).astype(x.dtype)


def _modulate(h, shift, scale):
    return h * (1.0 + scale) + shift


def _split_cols(p):
    idx = np.cumsum(IN_SPLITS)[:-1].tolist()
    return jnp.split(p, idx, axis=-1)


def _short_conv(b_gate, c_gate, h, conv_w):
    u = c_gate * h
    y = lax.conv_general_dilated(u, conv_w[:, None, :].astype(u.dtype), window_strides=(1,),
                                 padding=[(CONV_K // 2, CONV_K // 2)],
                                 dimension_numbers=('NWC', 'WIO', 'NWC'),
                                 feature_group_count=CONV_W)
    return b_gate * y


def _axial_rope_tables(rows):
    n = rows * GRID_W
    row = jnp.repeat(jnp.arange(rows, dtype=jnp.int32), GRID_W)
    col = jnp.arange(n, dtype=jnp.int32) % GRID_W
    inv = ROPE_THETA ** (-jnp.arange(ROPE_FREQS, dtype=jnp.float32) / ROPE_FREQS)
    ang_r = row[:, None].astype(jnp.float32) * inv[None, :]
    ang_c = col[:, None].astype(jnp.float32) * inv[None, :]
    return (jnp.cos(ang_r), jnp.sin(ang_r), jnp.cos(ang_c), jnp.sin(ang_c))


def _rotate(x, cos, sin):
    f = x.shape[-1] // 2
    x1, x2 = x[..., :f], x[..., f:]
    cs = cos[None, :, None, :].astype(x.dtype)
    sn = sin[None, :, None, :].astype(x.dtype)
    return jnp.concatenate([x1 * cs - x2 * sn, x1 * sn + x2 * cs], axis=-1)


def _axial_rope(x, tabs):
    cr, sr, cc, sc = tabs
    half = ATT_HEAD_DIM // 2
    return jnp.concatenate([_rotate(x[..., :half], cr, sr), _rotate(x[..., half:], cc, sc)], axis=-1)


def _window_attention(q, k, v, k_ctx, v_ctx, sinks):
    bsz, n = q.shape[0], q.shape[1]
    nb = n // ATT_BLOCK
    grp = ATT_HEADS // ATT_KV_HEADS
    qb = q.reshape(bsz, nb, ATT_BLOCK, ATT_KV_HEADS, grp, ATT_HEAD_DIM)

    def band(t):
        tp = jnp.pad(t, ((0, 0), (ATT_BLOCK, ATT_BLOCK), (0, 0), (0, 0)))
        tp = tp.reshape(bsz, nb + 2, ATT_BLOCK, ATT_KV_HEADS, ATT_HEAD_DIM)
        return jnp.concatenate([tp[:, :-2], tp[:, 1:-1], tp[:, 2:]], axis=2)

    kb, vb = band(k), band(v)
    scale = ATT_HEAD_DIM ** -0.5
    s_loc = jnp.einsum('bnqkgd,bnskd->bnkgqs', qb, kb).astype(jnp.float32) * scale
    blk = jnp.arange(nb)[:, None, None] * ATT_BLOCK
    qpos = blk + jnp.arange(ATT_BLOCK)[None, :, None]
    kpos = blk - ATT_BLOCK + jnp.arange(3 * ATT_BLOCK)[None, None, :]
    valid = (jnp.abs(kpos - qpos) <= WINDOW) & (kpos >= 0) & (kpos < n)
    s_loc = jnp.where(valid[None, :, None, None], s_loc, NEG_INF)
    s_ctx = jnp.einsum('bnqkgd,bckd->bnkgqc', qb, k_ctx).astype(jnp.float32) * scale
    sink = jnp.broadcast_to(
        sinks.astype(jnp.float32).reshape(ATT_KV_HEADS, grp)[None, None, :, :, None, None],
        s_loc.shape[:-1] + (1,))
    probs = jax.nn.softmax(jnp.concatenate([sink, s_ctx, s_loc], axis=-1), axis=-1)
    n_ctx = k_ctx.shape[1]
    p_ctx = probs[..., 1:1 + n_ctx].astype(v.dtype)
    p_loc = probs[..., 1 + n_ctx:].astype(v.dtype)
    o = (jnp.einsum('bnkgqc,bckd->bnqkgd', p_ctx, v_ctx)
         + jnp.einsum('bnkgqs,bnskd->bnqkgd', p_loc, vb))
    return o.reshape(bsz, n, ATT_W)


def _ctx_attention(q, k, v, sinks):
    bsz, length = q.shape[0], q.shape[1]
    grp = ATT_HEADS // ATT_KV_HEADS
    qg = q.reshape(bsz, length, ATT_KV_HEADS, grp, ATT_HEAD_DIM)
    s = jnp.einsum('bqkgd,bskd->bkgqs', qg, k).astype(jnp.float32) * (ATT_HEAD_DIM ** -0.5)
    sink = jnp.broadcast_to(
        sinks.astype(jnp.float32).reshape(ATT_KV_HEADS, grp)[None, :, :, None, None],
        s.shape[:-1] + (1,))
    p = jax.nn.softmax(jnp.concatenate([sink, s], axis=-1), axis=-1)[..., 1:].astype(v.dtype)
    o = jnp.einsum('bkgqs,bskd->bqkgd', p, v)
    return o.reshape(bsz, length, ATT_W)


def _heads(t):
    return t.reshape(t.shape[0], t.shape[1], RWKV_HEADS, RWKV_HEAD_DIM)


def _rwkv_prep(r, k, v, wd, ad, k_k, k_a, decay_base, decay_up, iclr_base, iclr_up):
    f32 = jnp.float32
    r, k, v = r.astype(f32), k.astype(f32), v.astype(f32)
    kk = _heads(k * k_k.astype(f32))
    kk = kk / jnp.maximum(jnp.sqrt(jnp.sum(kk * kk, axis=-1, keepdims=True)), 1e-12)
    dirs = []
    for d in range(2):
        z = (decay_base[d] + jnp.tanh(wd[d]) @ decay_up[d]).astype(f32)
        w_log = -jax.nn.softplus(-z) - 0.5
        decay = jnp.exp(-jnp.exp(w_log))
        a = jax.nn.sigmoid((iclr_base[d] + ad[d] @ iclr_up[d]).astype(f32))
        k_d = k * (1.0 + (a - 1.0) * k_a.astype(f32))
        dirs.append((_heads(decay), _heads(k_d), kk * _heads(a)))
    return _heads(r), _heads(v), kk, dirs


def _rwkv_scan(s0, r, decay, k, v, kk, b, reverse, emit):
    def step(S, inp):
        r_t, w_t, k_t, v_t, kk_t, b_t = inp
        sk = jnp.einsum('bhij,bhj->bhi', S, kk_t)
        S = S * w_t[:, :, None, :] - sk[..., None] * b_t[:, :, None, :] + v_t[..., None] * k_t[:, :, None, :]
        y = jnp.einsum('bhij,bhj->bhi', S, r_t) if emit else None
        return S, y

    xs = tuple(jnp.moveaxis(t, 1, 0) for t in (r, decay, k, v, kk, b))
    S, ys = lax.scan(step, s0, xs, reverse=reverse)
    return S, (jnp.moveaxis(ys, 0, 1) if emit else None)


def _rwkv_out(y, r, v, k_dirs, gd, r_k, lnx_w, lnx_b, gate_up, dtype):
    f32 = jnp.float32
    bsz, length = y.shape[0], y.shape[1]
    mu = jnp.mean(y, axis=-1, keepdims=True)
    var = jnp.mean(jnp.square(y - mu), axis=-1, keepdims=True)
    yn = ((y - mu) * lax.rsqrt(var + RWKV_GN_EPS)).reshape(bsz, length, RWKV_W)
    yn = yn * lnx_w.astype(f32) + lnx_b.astype(f32)
    rk = r_k.astype(f32)
    bonus = sum(jnp.sum(r * kd * rk, axis=-1, keepdims=True) * v for kd in k_dirs)
    o = yn + bonus.reshape(bsz, length, RWKV_W)
    g = jax.nn.sigmoid(gd) @ gate_up
    return (o * g.astype(f32)).astype(dtype)


def _token_mixers(p_ctx, p_lat, rope_tabs, conv_w, sinks, decay_base, decay_up, iclr_base, iclr_up,
                  gate_up, k_k, k_a, r_k, lnx_w, lnx_b, with_ctx_out):
    (cb_c, cc_c, ch_c, q_c, k_c, v_c, rr_c, rk_c, rv_c,
     wdf_c, wdb_c, adf_c, adb_c, gd_c) = _split_cols(p_ctx)
    (cb_l, cc_l, ch_l, q_l, k_l, v_l, rr_l, rk_l, rv_l,
     wdf_l, wdb_l, adf_l, adb_l, gd_l) = _split_cols(p_lat)
    bsz = p_lat.shape[0]
    dtype = p_lat.dtype

    def ahd(t, nh):
        return t.reshape(t.shape[0], t.shape[1], nh, ATT_HEAD_DIM)

    a_lat = _short_conv(cb_l, cc_l, ch_l, conv_w)

    kc, vc = ahd(k_c, ATT_KV_HEADS), ahd(v_c, ATT_KV_HEADS)
    ql = _axial_rope(ahd(q_l, ATT_HEADS), rope_tabs)
    kl = _axial_rope(ahd(k_l, ATT_KV_HEADS), rope_tabs)
    b_lat = _window_attention(ql, kl, ahd(v_l, ATT_KV_HEADS), kc, vc, sinks)

    r_c, vv_c, kk_c, dirs_c = _rwkv_prep(rr_c, rk_c, rv_c, (wdf_c, wdb_c), (adf_c, adb_c), k_k, k_a,
                                         decay_base, decay_up, iclr_base, iclr_up)
    r_l, vv_l, kk_l, dirs_l = _rwkv_prep(rr_l, rk_l, rv_l, (wdf_l, wdb_l), (adf_l, adb_l), k_k, k_a,
                                         decay_base, decay_up, iclr_base, iclr_up)
    s0 = jnp.zeros((bsz, RWKV_HEADS, RWKV_HEAD_DIM, RWKV_HEAD_DIM), jnp.float32)
    dec_cf, k_cf, b_cf = dirs_c[0]
    dec_cb, k_cb, b_cb = dirs_c[1]
    s_f, yc_f = _rwkv_scan(s0, r_c, dec_cf, k_cf, vv_c, kk_c, b_cf, reverse=False, emit=with_ctx_out)
    s_b, yc_b = _rwkv_scan(s0, r_c, dec_cb, k_cb, vv_c, kk_c, b_cb, reverse=True, emit=with_ctx_out)
    dec_lf, k_lf, b_lf = dirs_l[0]
    dec_lb, k_lb, b_lb = dirs_l[1]
    _, yl_f = _rwkv_scan(s_f, r_l, dec_lf, k_lf, vv_l, kk_l, b_lf, reverse=False, emit=True)
    _, yl_b = _rwkv_scan(s_b, r_l, dec_lb, k_lb, vv_l, kk_l, b_lb, reverse=True, emit=True)
    c_lat = _rwkv_out(yl_f + yl_b, r_l, vv_l, (k_lf, k_lb), gd_l, r_k, lnx_w, lnx_b, gate_up, dtype)

    mix_lat = jnp.concatenate([a_lat, b_lat, c_lat], axis=-1)
    if not with_ctx_out:
        return mix_lat, None
    a_ctx = _short_conv(cb_c, cc_c, ch_c, conv_w)
    b_ctx = _ctx_attention(ahd(q_c, ATT_HEADS), kc, vc, sinks)
    c_ctx_out = _rwkv_out(yc_f + yc_b, r_c, vv_c, (k_cf, k_cb), gd_c, r_k, lnx_w, lnx_b, gate_up, dtype)
    mix_ctx = jnp.concatenate([a_ctx, b_ctx, c_ctx_out], axis=-1)
    return mix_lat, mix_ctx


def _moe(h, router_w, router_b, w_gate, w_up, w_down):
    n_tok, d = h.shape
    scores = jax.nn.sigmoid((h @ router_w).astype(jnp.float32))
    sel = scores + router_b.astype(jnp.float32)
    grp = sel.reshape(n_tok, N_EXPERT_GROUPS, EXPERTS_PER_GROUP)
    grp_score = jnp.sum(lax.top_k(grp, 2)[0], axis=-1)
    best = jnp.argmax(grp_score, axis=-1)
    in_grp = (jnp.arange(N_EXPERT_GROUPS)[None, :] == best[:, None])[:, :, None]
    masked = jnp.where(in_grp, grp, NEG_INF).reshape(n_tok, N_EXPERTS)
    idx = lax.top_k(masked, TOP_K)[1]
    gate = jnp.take_along_axis(scores, idx, axis=1)
    gate = gate / jnp.sum(gate, axis=-1, keepdims=True)

    n_asg = n_tok * TOP_K
    e_flat = idx.reshape(n_asg)
    tok_flat = jnp.arange(n_asg, dtype=jnp.int32) // TOP_K
    w_flat = gate.reshape(n_asg)
    order = jnp.argsort(e_flat)
    e_sorted = e_flat[order]
    counts = jnp.bincount(e_flat, length=N_EXPERTS)
    starts = jnp.cumsum(counts) - counts
    padded = (counts + MOE_BLOCK - 1) // MOE_BLOCK * MOE_BLOCK
    pends = jnp.cumsum(padded)
    pstarts = pends - padded
    dest = pstarts[e_sorted] + (jnp.arange(n_asg) - starts[e_sorted])
    n_blk = (n_asg + MOE_BLOCK - 1) // MOE_BLOCK + N_EXPERTS
    cap = n_blk * MOE_BLOCK
    buf_tok = jnp.full((cap,), n_tok, jnp.int32).at[dest].set(tok_flat[order])
    buf_w = jnp.zeros((cap,), h.dtype).at[dest].set(w_flat[order].astype(h.dtype))
    block_e = jnp.minimum(jnp.searchsorted(pends, jnp.arange(n_blk) * MOE_BLOCK, side='right'),
                          N_EXPERTS - 1)
    h_pad = jnp.concatenate([h, jnp.zeros((1, d), h.dtype)], axis=0)
    xb = h_pad[buf_tok].reshape(n_blk, MOE_BLOCK, d)

    def expert_block(args):
        xblk, e = args
        g = xblk @ w_gate[e]
        u = xblk @ w_up[e]
        return (jax.nn.silu(g) * u) @ w_down[e]

    yb = lax.map(expert_block, (xb, block_e)).reshape(cap, d)
    out = jnp.zeros((n_tok + 1, d), h.dtype).at[buf_tok].add(yb * buf_w[:, None])
    return out[:n_tok]


def setup_inputs(seed: int = 0) -> dict:
    key = jax.random.key(seed)
    ks = iter(jax.random.split(key, 40))
    D = D_MODEL

    def nrm(shape, scale):
        return scale * jax.random.normal(next(ks), shape, jnp.float32)

    return {
        "x": nrm((BATCH, SEQ, D), 1.0),
        "c": nrm((BATCH, D), 1.0),
        "ctx": nrm((BATCH, CTX_LEN, D), 1.0),
        "c_ctx": nrm((D,), 1.0),
        "ada_w": nrm((DEPTH, D, 6 * D), 0.5 * D ** -0.5),
        "ada_b": nrm((DEPTH, 6 * D), 0.02),
        "norm1_g": 1.0 + nrm((DEPTH, D), 0.02),
        "norm2_g": 1.0 + nrm((DEPTH, D), 0.02),
        "w_in": nrm((DEPTH, D, IN_W), D ** -0.5),
        "w_out": nrm((DEPTH, MIX_W, D), MIX_W ** -0.5),
        "conv_w": nrm((DEPTH, CONV_K, CONV_W), CONV_K ** -0.5),
        "attn_sinks": nrm((DEPTH, ATT_HEADS), 0.5),
        "decay_base": nrm((DEPTH, 2, RWKV_W), 0.5) - 0.5,
        "decay_up": nrm((DEPTH, 2, DECAY_RANK, RWKV_W), 0.5 * DECAY_RANK ** -0.5),
        "iclr_base": nrm((DEPTH, 2, RWKV_W), 0.5),
        "iclr_up": nrm((DEPTH, 2, ICLR_RANK, RWKV_W), 0.5 * ICLR_RANK ** -0.5),
        "gate_up": nrm((DEPTH, GATE_RANK, RWKV_W), GATE_RANK ** -0.5),
        "k_k": 0.85 + nrm((DEPTH, RWKV_W), 0.02),
        "k_a": 1.0 + nrm((DEPTH, RWKV_W), 0.02),
        "r_k": nrm((DEPTH, RWKV_HEADS, RWKV_HEAD_DIM), 0.1),
        "lnx_w": 1.0 + nrm((DEPTH, RWKV_W), 0.02),
        "lnx_b": nrm((DEPTH, RWKV_W), 0.02),
        "router_w": nrm((D, N_EXPERTS), D ** -0.5),
        "router_b": nrm((N_EXPERTS,), 0.01),
        "expert_gate": nrm((DEPTH, N_EXPERTS, D, D_EXPERT), D ** -0.5),
        "expert_up": nrm((DEPTH, N_EXPERTS, D, D_EXPERT), D ** -0.5),
        "expert_down": nrm((DEPTH, N_EXPERTS, D_EXPERT, D), D_EXPERT ** -0.5),
        "final_norm_g": 1.0 + nrm((D,), 0.02),
    }


def reference(x, c, ctx, c_ctx, ada_w, ada_b, norm1_g, norm2_g, w_in, w_out, conv_w, attn_sinks,
              decay_base, decay_up, iclr_base, iclr_up, gate_up, k_k, k_a, r_k, lnx_w, lnx_b,
              router_w, router_b, expert_gate, expert_up, expert_down, final_norm_g):
    bsz, n_lat, d = x.shape
    rows = n_lat // GRID_W
    rope_tabs = _axial_rope_tables(rows)
    silu_c = jax.nn.silu(c)
    silu_cc = jax.nn.silu(c_ctx)
    for l in range(DEPTH):
        last = l == DEPTH - 1
        sh1, sc1, g1, sh2, sc2, g2 = [m[:, None, :] for m in
                                      jnp.split(silu_c @ ada_w[l] + ada_b[l], 6, axis=-1)]
        csh1, csc1, cg1, csh2, csc2, cg2 = jnp.split(silu_cc @ ada_w[l] + ada_b[l], 6, axis=-1)

        h_lat = _modulate(_rms_norm(x, norm1_g[l]), sh1, sc1)
        h_ctx = _modulate(_rms_norm(ctx, norm1_g[l]), csh1, csc1)
        mix_lat, mix_ctx = _token_mixers(h_ctx @ w_in[l], h_lat @ w_in[l], rope_tabs, conv_w[l],
                                         attn_sinks[l], decay_base[l], decay_up[l], iclr_base[l],
                                         iclr_up[l], gate_up[l], k_k[l], k_a[l], r_k[l], lnx_w[l],
                                         lnx_b[l], with_ctx_out=not last)
        x = x + g1 * (mix_lat @ w_out[l])

        h2_lat = _modulate(_rms_norm(x, norm2_g[l]), sh2, sc2).reshape(bsz * n_lat, d)
        if last:
            y_lat = _moe(h2_lat, router_w, router_b, expert_gate[l], expert_up[l], expert_down[l])
        else:
            ctx = ctx + cg1 * (mix_ctx @ w_out[l])
            h2_ctx = _modulate(_rms_norm(ctx, norm2_g[l]), csh2, csc2).reshape(-1, d)
            n_ctx_tok = h2_ctx.shape[0]
            y_all = _moe(jnp.concatenate([h2_ctx, h2_lat], axis=0), router_w, router_b,
                         expert_gate[l], expert_up[l], expert_down[l])
            ctx = ctx + cg2 * y_all[:n_ctx_tok].reshape(ctx.shape)
            y_lat = y_all[n_ctx_tok:]
        x = x + g2 * y_lat.reshape(x.shape)
    return _rms_norm(x, final_norm_g)
```

```cpp
#include <hip/hip_runtime.h>
#include <cstdio>
#include <cstdint>

#define DI __device__ __forceinline__
#define LAS __attribute__((address_space(3)))
typedef unsigned short bf16_t;
typedef short bf16x8 __attribute__((ext_vector_type(8)));
typedef short s16x4 __attribute__((ext_vector_type(4)));
typedef float f32x4 __attribute__((ext_vector_type(4)));
typedef float f32x2 __attribute__((ext_vector_type(2)));
typedef float f32x16 __attribute__((ext_vector_type(16)));
typedef unsigned u32x4 __attribute__((ext_vector_type(4)));
typedef unsigned u32x2 __attribute__((ext_vector_type(2)));
typedef LAS unsigned char* lptr;

#ifndef MK_PER_PHASE
#define MK_PER_PHASE 0
#endif

constexpr int D = 2048, NLAT = 16384, NCTX = 256, NT = NLAT + NCTX, INW = 5504, NE = 32, DE = 768;
constexpr int C_CB = 0, C_CC = 512, C_CH = 1024, C_Q = 1536, C_K = 2304, C_V = 2560, C_RR = 2816, C_RK = 3584, C_RV = 4352,
              C_WD = 5120  , C_AD = 5248  , C_GD = 5376;
constexpr int NCHUNK = NT / 64;
constexpr int NTHREADS = 512;
constexpr int MAXTILES = 163;

constexpr size_t al256(size_t x) { return (x + 255) & ~(size_t)255; }
constexpr size_t WS_CTL = 0;
constexpr size_t CTL_BYTES = 65536;
constexpr size_t WS_MOD = WS_CTL + CTL_BYTES;
constexpr size_t WS_ROPE = WS_MOD + al256((size_t)2 * 2 * 6 * D * 4);
constexpr size_t WS_WFRAG = WS_ROPE + al256((size_t)(256 + 64) * 16 * 8);
constexpr size_t WS_GUF = WS_WFRAG + (size_t)2 * 64 * 2 * 64 * 16;
constexpr size_t WS_DUF = WS_GUF + (size_t)2 * 12 * 16 * 64 * 16;
constexpr size_t WS_IUF = WS_DUF + (size_t)2 * 2 * 12 * 8 * 64 * 16;
constexpr size_t WS_X = WS_IUF + (size_t)2 * 2 * 12 * 8 * 64 * 16;
constexpr size_t WS_SSQ = WS_X + (size_t)NT * D * 4;
constexpr size_t WS_H = WS_SSQ + (size_t)NT * 32 * 4;
constexpr size_t WS_P = WS_H + (size_t)NT * D * 2;
constexpr size_t WS_MIX = WS_P + (size_t)NT * INW * 2;
constexpr size_t WS_RW1 = WS_MIX + (size_t)NT * D * 2;
constexpr size_t WS_SBUF = WS_RW1 + (size_t)2 * 12 * NCHUNK * 4 * 4096 * 2;
constexpr size_t WS_BONUS = WS_SBUF + (size_t)2 * 12 * NCHUNK * 4096 * 2;
constexpr size_t WS_TI = WS_BONUS + (size_t)2 * NT * 12 * 4;
constexpr size_t WS_TW = WS_TI + (size_t)NT * 16;
constexpr size_t WS_LIST = WS_TW + (size_t)NT * 8;
constexpr size_t WS_ACT = WS_LIST + (size_t)NE * NT * 4;
constexpr size_t WS_YB = WS_ACT + (size_t)MAXTILES * 256 * DE * 2;
constexpr size_t WS_END = WS_YB + (size_t)MAXTILES * 256 * D * 2;
constexpr int CW_BAR = 0;
constexpr int CW_CNT = 4096;

constexpr int SA = 144, SB = 576;
constexpr int G_A0 = 0, G_A1 = 256 * SA, G_B0 = 2 * 256 * SA, G_B1 = G_B0 + 64 * SB;
constexpr int LDS_GEMM = G_B1 + 64 * SB;
constexpr int SS = 72;
constexpr int IMG = 64 * SS * 2;
constexpr int LDS_XB = LDS_GEMM;
constexpr int LDS_BYTES = LDS_GEMM + 16 + 256;

struct Params {
    const float *x, *c, *ctx, *c_ctx, *ada_w, *ada_b, *norm1_g, *norm2_g, *w_in, *w_out, *conv_w, *sinks, *decay_base, *decay_up, *iclr_base, *iclr_up,
        *gate_up, *k_k, *k_a, *r_k, *lnx_w, *lnx_b, *router_w, *router_b, *e_gate, *e_up, *e_down, *final_g;
    float* out; unsigned char* ws; int ph_lo, ph_hi;
};

typedef __bf16 bf16x2_t __attribute__((ext_vector_type(2)));
DI unsigned pk2(float lo, float hi) { const f32x2 v = {lo, hi}; return __builtin_bit_cast(unsigned, __builtin_convertvector(v, bf16x2_t)); }
DI float bflo(unsigned u) { return __uint_as_float(u << 16); }
DI float bfhi(unsigned u) { return __uint_as_float(u & 0xffff0000u); }
DI float bf2f(bf16_t b) { return __uint_as_float(((unsigned)b) << 16); }
DI bf16_t f2bf(float f) { return __builtin_bit_cast(bf16_t, (__bf16)f); }
DI void unpack8(const u32x4& v, float (&f)[8]) { f[0] = bflo(v.x); f[1] = bfhi(v.x); f[2] = bflo(v.y); f[3] = bfhi(v.y); f[4] = bflo(v.z); f[5] = bfhi(v.z); f[6] = bflo(v.w); f[7] = bfhi(v.w); }
DI u32x4 pack8(const float (&f)[8]) { u32x4 v; v.x = pk2(f[0], f[1]); v.y = pk2(f[2], f[3]); v.z = pk2(f[4], f[5]); v.w = pk2(f[6], f[7]); return v; }
DI float sigmoidf_(float x) { return 1.0f / (1.0f + __expf(-x)); }
DI float wave_sum(float v) { for (int o = 32; o > 0; o >>= 1) v += __shfl_xor(v, o); return v; }
DI f32x4 mfma16(bf16x8 a, bf16x8 b, f32x4 c) { return __builtin_amdgcn_mfma_f32_16x16x32_bf16(a, b, c, 0, 0, 0); }
DI f32x16 mfma32(bf16x8 a, bf16x8 b, f32x16 c) { return __builtin_amdgcn_mfma_f32_32x32x16_bf16(a, b, c, 0, 0, 0); }
DI bf16x8 as_frag(u32x4 v) { return __builtin_bit_cast(bf16x8, v); }
DI bf16x8 lds_frag(lptr p) { return *(LAS bf16x8*)p; }
DI bf16x8 lds_tr_pair(lptr p0, lptr p1) {
    s16x4 lo = __builtin_amdgcn_ds_read_tr16_b64_v4i16((LAS s16x4*)p0), hi = __builtin_amdgcn_ds_read_tr16_b64_v4i16((LAS s16x4*)p1);
    return __builtin_shufflevector(lo, hi, 0, 1, 2, 3, 4, 5, 6, 7);
}

#define XB_TMO      128
#define XB_XCNT(j)  (256  + 64 * (j))
#define XB_XSUB(j)  (1280 + 64 * (j))
#define XB_XGEN(j)  (2304 + 64 * (j))
#define XB_TOP      3328
#define XB_TOPGEN   3392
#define XCD_BAR_WORDS 3456
#define XB_SPIN_CAP (1u << 18)
__device__ __forceinline__ unsigned xb_ld(unsigned* p)              { return __hip_atomic_load(p, __ATOMIC_RELAXED, __HIP_MEMORY_SCOPE_AGENT); }
__device__ __forceinline__ unsigned xb_add(unsigned* p, unsigned v) { return __hip_atomic_fetch_add(p, v, __ATOMIC_RELAXED, __HIP_MEMORY_SCOPE_AGENT); }
__device__ __forceinline__ unsigned xb_xcc_id() { return (unsigned)__builtin_amdgcn_s_getreg((3 << 11) | 20) & 0xFu; }
#define XB_SPIN(cond, bar) do { unsigned _sp = 0; while (cond) { __builtin_amdgcn_s_sleep(1); \
    if ((++_sp & 255u) == 0u) { if (xb_ld(&(bar)[XB_TMO])) break; if (_sp > XB_SPIN_CAP) { atomicAdd(&(bar)[XB_TMO], 1u); break; } } } } while (0)
struct XcdBarrier { unsigned* bar; unsigned x; volatile LAS unsigned* st; };
__device__ __forceinline__ XcdBarrier xcd_barrier_post(unsigned* bar, volatile LAS unsigned* st) {
    XcdBarrier b; b.bar = bar; b.x = xb_xcc_id(); b.st = st;
    if (threadIdx.x == 0) (void)xb_add(&bar[XB_XCNT(b.x)], 1u);
    return b;
}
__device__ __forceinline__ void xcd_barrier_complete(unsigned* bar, unsigned x, unsigned& nloc, unsigned& nx) {
    const unsigned G = gridDim.x * gridDim.y * gridDim.z;
    unsigned sum, cnt, mine, sp = 0u;
    for (;;) {
        sum = 0u; cnt = 0u; mine = 0u;
#pragma unroll
        for (unsigned j = 0; j < 16; ++j) { const unsigned c = xb_ld(&bar[XB_XCNT(j)]); sum += c; cnt += (c > 0u) ? 1u : 0u; mine = (j == x) ? c : mine; }
        if (sum == G) break;
        __builtin_amdgcn_s_sleep(1);
        if ((++sp & 255u) == 0u) { if (xb_ld(&bar[XB_TMO])) break; if (sp > XB_SPIN_CAP) { atomicAdd(&bar[XB_TMO], 1u); break; } }
    }
    nloc = mine > 0u ? mine : 1u; nx = cnt > 0u ? cnt : 1u;
}
__device__ __forceinline__ void xcd_barrier(const XcdBarrier& b) {
    asm volatile("s_waitcnt vmcnt(0)" ::: "memory");
    __syncthreads();
    if (threadIdx.x == 0) {
        unsigned* bar = b.bar;
        __builtin_amdgcn_s_waitcnt(0);
        unsigned nloc = b.st[0], nx = b.st[1];
        if (nloc == 0u) { xcd_barrier_complete(bar, b.x, nloc, nx); b.st[0] = nloc; b.st[1] = nx; }
        const unsigned old = xb_add(&bar[XB_XSUB(b.x)], 1u);
        const unsigned gen = old / nloc;
        if (old + 1u == (gen + 1u) * nloc) {
            __builtin_amdgcn_fence(__ATOMIC_RELEASE, "agent");
            asm volatile("s_waitcnt vmcnt(0)" ::: "memory");
            const unsigned og = xb_add(&bar[XB_TOP], 1u);
            const unsigned tg = og / nx;
            if (og + 1u == (tg + 1u) * nx) xb_add(&bar[XB_TOPGEN], 1u);
            else XB_SPIN(xb_ld(&bar[XB_TOPGEN]) == tg, bar);
            __builtin_amdgcn_fence(__ATOMIC_ACQUIRE, "agent");
            xb_add(&bar[XB_XGEN(b.x)], 1u);
            asm volatile("s_waitcnt vmcnt(0)" ::: "memory");
        } else {
            XB_SPIN(xb_ld(&bar[XB_XGEN(b.x)]) == gen, bar);
            __builtin_amdgcn_fence(__ATOMIC_ACQUIRE, "agent");
            asm volatile("s_waitcnt vmcnt(0)" ::: "memory");
        }
    }
    __syncthreads();
}

struct GemmRegs { u32x4 a[4]; f32x4 b[8]; };
template <class AL, class BL>
DI void gemm_mainloop(lptr lds, int nkt, const AL& al, const BL& bl, f32x16 (&acc)[4][2], int tid) {
    const int lane = tid & 63, w = tid >> 6, wr = w >> 2, wc = w & 3;
    const int r = lane & 31, h = lane >> 5, blk = (lane >> 4) & 1, qq = (lane & 15) >> 2, pp = lane & 3;
#pragma unroll
    for (int mt = 0; mt < 4; ++mt)
#pragma unroll
        for (int nt = 0; nt < 2; ++nt)
#pragma unroll
            for (int i = 0; i < 16; ++i) acc[mt][nt][i] = 0.f;
    const int sa_off = (tid >> 3) * SA + (tid & 7) * 16;
    const int sb_off = (tid >> 6) * 8 * SB + (tid & 63) * 8;
    const int fa_off = (128 * wr + r) * SA + h * 16;
    const int fb_off = (8 * h + qq) * SB + (64 * wc + 16 * blk) * 2 + 8 * pp;
    GemmRegs g;
    al(g.a, 0); bl(g.b, 0);
    {
        lptr As = lds + G_A0, Bs = lds + G_B0;
#pragma unroll
        for (int i = 0; i < 4; ++i) *(LAS u32x4*)(As + sa_off + i * 64 * SA) = g.a[i];
#pragma unroll
        for (int i = 0; i < 8; ++i) { u32x2 v; v.x = pk2(g.b[i].x, g.b[i].y); v.y = pk2(g.b[i].z, g.b[i].w); *(LAS u32x2*)(Bs + sb_off + i * SB) = v; }
    }
    __syncthreads();
    for (int kt = 0; kt < nkt; ++kt) {
        const bool more = (kt + 1 < nkt);
        if (more) { al(g.a, kt + 1); bl(g.b, kt + 1); }
        lptr As = lds + ((kt & 1) ? G_A1 : G_A0), Bs = lds + ((kt & 1) ? G_B1 : G_B0);
#pragma unroll
        for (int s = 0; s < 4; ++s) {
            bf16x8 af[4], bfr[2];
#pragma unroll
            for (int mt = 0; mt < 4; ++mt) af[mt] = lds_frag(As + fa_off + mt * 32 * SA + s * 32);
#pragma unroll
            for (int nt = 0; nt < 2; ++nt) bfr[nt] = lds_tr_pair(Bs + fb_off + s * 16 * SB + nt * 64, Bs + fb_off + s * 16 * SB + nt * 64 + 4 * SB);
#pragma unroll
            for (int mt = 0; mt < 4; ++mt)
#pragma unroll
                for (int nt = 0; nt < 2; ++nt) acc[mt][nt] = mfma32(af[mt], bfr[nt], acc[mt][nt]);
        }
        if (more) {
            lptr An = lds + ((kt & 1) ? G_A0 : G_A1), Bn = lds + ((kt & 1) ? G_B0 : G_B1);
#pragma unroll
            for (int i = 0; i < 4; ++i) *(LAS u32x4*)(An + sa_off + i * 64 * SA) = g.a[i];
#pragma unroll
            for (int i = 0; i < 8; ++i) { u32x2 v; v.x = pk2(g.b[i].x, g.b[i].y); v.y = pk2(g.b[i].z, g.b[i].w); *(LAS u32x2*)(Bn + sb_off + i * SB) = v; }
        }
        __syncthreads();
    }
}
struct ALoad {
    const bf16_t* base; unsigned row[4];
    DI void operator()(u32x4 (&a)[4], int kt) const {
#pragma unroll
        for (int i = 0; i < 4; ++i) a[i] = *(const u32x4*)(base + (size_t)(row[i] + (unsigned)kt * 64u));
    }
};
struct BLoad {
    const float* base; size_t ldb; bool valid;
    DI void operator()(f32x4 (&b)[8], int kt) const {
        if (valid) {
#pragma unroll
            for (int i = 0; i < 8; ++i) b[i] = *(const f32x4*)(base + ((size_t)kt * 64 + i) * ldb);
        } else {
#pragma unroll
            for (int i = 0; i < 8; ++i) b[i] = (f32x4){0.f, 0.f, 0.f, 0.f};
        }
    }
};
DI int crow32(int i, int h) { return (i & 3) + 8 * (i >> 2) + 4 * h; }

DI bf16x8 frag_n(lptr img, int t, int ks, int lane) { return lds_frag(img + ((16 * t + (lane & 15)) * SS + 32 * ks + 8 * (lane >> 4)) * 2); }
DI bf16x8 frag_t(lptr img, int t, int ks, int lane) {
    const int g = lane >> 4, q = (lane & 15) >> 2, p = lane & 3;
    lptr a = img + ((32 * ks + 8 * g + q) * SS + 16 * t + 4 * p) * 2;
    return lds_tr_pair(a, a + 4 * SS * 2);
}
template <bool AT, bool BN, class Epi>
DI void mm64(lptr A, lptr B, int w, int lane, const Epi& epi) {
    const int mt = w >> 1;
    const bf16x8 a0 = AT ? frag_t(A, mt, 0, lane) : frag_n(A, mt, 0, lane), a1 = AT ? frag_t(A, mt, 1, lane) : frag_n(A, mt, 1, lane);
#pragma unroll
    for (int nn = 0; nn < 2; ++nn) {
        const int nt = 2 * (w & 1) + nn;
        const bf16x8 b0 = BN ? frag_t(B, nt, 0, lane) : frag_n(B, nt, 0, lane), b1 = BN ? frag_t(B, nt, 1, lane) : frag_n(B, nt, 1, lane);
        f32x4 acc = {0.f, 0.f, 0.f, 0.f};
        acc = mfma16(a0, b0, acc); acc = mfma16(a1, b1, acc);
        epi(mt, nt, acc);
    }
}
DI void img_store(lptr img, int mt, int nt, int lane, const f32x4& v) {
    const int r0 = 16 * mt + 4 * (lane >> 4), c = 16 * nt + (lane & 15);
#pragma unroll
    for (int jj = 0; jj < 4; ++jj) *(LAS bf16_t*)(img + ((r0 + jj) * SS + c) * 2) = f2bf(v[jj]);
}
DI void img_store_t(lptr img, int mt, int nt, int lane, const f32x4& v) {
    const int r0 = 16 * mt + 4 * (lane >> 4), c = 16 * nt + (lane & 15);
    u32x2 o; o.x = pk2(v[0], v[1]); o.y = pk2(v[2], v[3]);
    *(LAS u32x2*)(img + (c * SS + r0) * 2) = o;
}
DI float img_ld(lptr img, int row, int col) { return bf2f(*(LAS bf16_t*)(img + (row * SS + col) * 2)); }

DI void phase_ada(const Params& p, lptr lds, int tid) {
    float* mod = (float*)(p.ws + WS_MOD);
    LAS float* sc = (LAS float*)lds;
    LAS float* red = (LAS float*)(lds + 16384);
    for (int i = tid; i < 2 * D; i += NTHREADS) { const float v = (i < D) ? p.c[i] : p.c_ctx[i - D]; sc[i] = v * sigmoidf_(v); }
    __syncthreads();
    const int c4 = tid & 15, kr = tid >> 4;
    for (int u = blockIdx.x; u < 2 * 192; u += gridDim.x) {
        const int l = u / 192, col0 = (u % 192) * 64;
        const float* wp = p.ada_w + (size_t)l * D * 6 * D + col0 + 4 * c4;
        f32x4 a0 = {0.f, 0.f, 0.f, 0.f}, a1 = {0.f, 0.f, 0.f, 0.f};
#pragma unroll 8
        for (int k = kr; k < D; k += 32) {
            const f32x4 wv = *(const f32x4*)(wp + (size_t)k * 6 * D);
            a0 += wv * sc[k]; a1 += wv * sc[D + k];
        }
#pragma unroll
        for (int j = 0; j < 4; ++j) { red[tid * 8 + j] = a0[j]; red[tid * 8 + 4 + j] = a1[j]; }
        __syncthreads();
        if (tid < 128) {
            const int src = tid >> 6, col = tid & 63;
            float s = 0.f;
            for (int k = 0; k < 32; ++k) s += red[(k * 16 + (col >> 2)) * 8 + src * 4 + (col & 3)];
            mod[((size_t)l * 2 + src) * 6 * D + col0 + col] = s + p.ada_b[(size_t)l * 6 * D + col0 + col];
        }
        __syncthreads();
    }
    const int gid = blockIdx.x * NTHREADS + tid, gsz = gridDim.x * NTHREADS;
    f32x2* tab = (f32x2*)(p.ws + WS_ROPE);
    for (int i = gid; i < 320 * 16; i += gsz) {
        const int pos = (i >> 4) < 256 ? (i >> 4) : (i >> 4) - 256, f = i & 15;
        const float inv = powf(10000.0f, -(float)f / 16.0f), ang = (float)pos * inv;
        tab[i] = (f32x2){cosf(ang), sinf(ang)};
    }
    u32x4* wfrag = (u32x4*)(p.ws + WS_WFRAG);
    for (int i = gid; i < 64 * 2 * 64; i += gsz) {
        const int lane = i & 63, nt = (i >> 6) & 1, s = i >> 7;
        float hi[8], lo[8];
#pragma unroll
        for (int j = 0; j < 8; ++j) { const float v = p.router_w[(size_t)(32 * s + 8 * (lane >> 4) + j) * NE + 16 * nt + (lane & 15)]; const float h = bf2f(f2bf(v)); hi[j] = h; lo[j] = v - h; }
        wfrag[i] = pack8(hi); wfrag[64 * 2 * 64 + i] = pack8(lo);
    }
    u32x4* guf = (u32x4*)(p.ws + WS_GUF);
    for (int i = gid; i < 2 * 12 * 16 * 64; i += gsz) {
        const int lane = i & 63, mt = (i >> 6) & 3, ks = (i >> 8) & 3, lh = i >> 10, h = lh % 12, l = lh / 12;
        float v[8];
#pragma unroll
        for (int j = 0; j < 8; ++j) v[j] = p.gate_up[((size_t)l * 128 + 32 * ks + 8 * (lane >> 4) + j) * 768 + 64 * h + 16 * mt + (lane & 15)];
        guf[i] = pack8(v);
    }
    u32x4* duf = (u32x4*)(p.ws + WS_DUF); u32x4* iuf = (u32x4*)(p.ws + WS_IUF);
    for (int i = gid; i < 2 * 2 * 12 * 8 * 64; i += gsz) {
        const int lane = i & 63, nt = (i >> 6) & 3, ks = (i >> 8) & 1, ldh = i >> 9, h = ldh % 12, ld = ldh / 12;
        float v[8], u[8];
#pragma unroll
        for (int j = 0; j < 8; ++j) {
            const size_t o = ((size_t)ld * 64 + 32 * ks + 8 * (lane >> 4) + j) * 768 + 64 * h + 16 * nt + (lane & 15);
            v[j] = p.decay_up[o]; u[j] = p.iclr_up[o];
        }
        duf[i] = pack8(v); iuf[i] = pack8(u);
    }
}

template <int MODE>
DI void phase_norm1(const Params& p, lptr lds, int tid) {
    const int lane = tid & 63, w = tid >> 6;
    const float* mod = (const float*)(p.ws + WS_MOD);
    float* X = (float*)(p.ws + WS_X);
    bf16_t* H = (bf16_t*)(p.ws + WS_H);
    LAS int* tb = (LAS int*)lds;
    if (MODE != 0) {
        const unsigned* cnt = (const unsigned*)(p.ws + WS_CTL) + CW_CNT + (MODE == 1 ? 0 : 32);
        if (tid == 0) { int acc = 0; for (int e = 0; e < NE; ++e) { tb[e] = acc; acc += (int)((cnt[e] + 255u) >> 8); } }
        __syncthreads();
    }
    const int L = (MODE == 0) ? 0 : 1;
    const int LC = (MODE == 1) ? 0 : 1;
    const int row_lo = (MODE == 2) ? NCTX : 0;
    for (int row = row_lo + blockIdx.x * 8 + w; row < NT; row += gridDim.x * 8) {
        const int sidx = row < NCTX ? 1 : 0;
        f32x4 v[8];
        if (MODE == 0) {
            const float* src = row < NCTX ? p.ctx + (size_t)row * D : p.x + (size_t)(row - NCTX) * D;
#pragma unroll
            for (int i = 0; i < 8; ++i) v[i] = *(const f32x4*)(src + 4 * lane + 256 * i);
        } else {
            const int4 ti = ((const int4*)(p.ws + WS_TI))[row];
            const f32x2 tw = ((const f32x2*)(p.ws + WS_TW))[row];
            const int e0 = ti.x & 255, e1 = (ti.x >> 8) & 255;
            const bf16_t* y0 = (const bf16_t*)(p.ws + WS_YB) + ((size_t)tb[e0] * 256 + ti.y) * D;
            const bf16_t* y1 = (const bf16_t*)(p.ws + WS_YB) + ((size_t)tb[e1] * 256 + ti.z) * D;
            const float* g2 = mod + ((size_t)LC * 2 + sidx) * 6 * D + 5 * D;
#pragma unroll
            for (int i = 0; i < 8; ++i) {
                const int col = 4 * lane + 256 * i;
                f32x4 xv = *(const f32x4*)(X + (size_t)row * D + col);
                const u32x2 a = *(const u32x2*)(y0 + col), b = *(const u32x2*)(y1 + col);
                const f32x4 gv = *(const f32x4*)(g2 + col);
                xv[0] += gv[0] * (tw.x * bflo(a.x) + tw.y * bflo(b.x)); xv[1] += gv[1] * (tw.x * bfhi(a.x) + tw.y * bfhi(b.x));
                xv[2] += gv[2] * (tw.x * bflo(a.y) + tw.y * bflo(b.y)); xv[3] += gv[3] * (tw.x * bfhi(a.y) + tw.y * bfhi(b.y));
                v[i] = xv;
                if (MODE == 1) *(f32x4*)(X + (size_t)row * D + col) = xv;
            }
        }
        float ss = 0.f;
#pragma unroll
        for (int i = 0; i < 8; ++i) ss += v[i][0] * v[i][0] + v[i][1] * v[i][1] + v[i][2] * v[i][2] + v[i][3] * v[i][3];
        ss = wave_sum(ss);
        const float rstd = rsqrtf(ss * (1.0f / D) + 1e-6f);
        if (MODE == 2) {
#pragma unroll
            for (int i = 0; i < 8; ++i) {
                const int col = 4 * lane + 256 * i;
                const f32x4 g = *(const f32x4*)(p.final_g + col);
                *(f32x4*)(p.out + (size_t)(row - NCTX) * D + col) = v[i] * rstd * g;
            }
        } else {
            const float* ng = p.norm1_g + (size_t)L * D;
            const float* sh = mod + ((size_t)L * 2 + sidx) * 6 * D, *sc = sh + D;
#pragma unroll
            for (int i = 0; i < 8; ++i) {
                const int col = 4 * lane + 256 * i;
                const f32x4 g = *(const f32x4*)(ng + col), s1 = *(const f32x4*)(sc + col), s0 = *(const f32x4*)(sh + col);
                const f32x4 hv = v[i] * rstd * g * (s1 + 1.0f) + s0;
                u32x2 o; o.x = pk2(hv[0], hv[1]); o.y = pk2(hv[2], hv[3]);
                *(u32x2*)(H + (size_t)row * D + col) = o;
            }
        }
    }
}

DI void phase_inproj(const Params& p, lptr lds, int tid, int l) {
    const bf16_t* H = (const bf16_t*)(p.ws + WS_H);
    bf16_t* P = (bf16_t*)(p.ws + WS_P);
    const float* W = p.w_in + (size_t)l * D * INW;
    const int lane = tid & 63, w = tid >> 6, wr = w >> 2, wc = w & 3, r = lane & 31, h = lane >> 5;
    constexpr int NRT = NT / 256, NCT = (INW + 255) / 256;
    for (int u = blockIdx.x; u < NRT * NCT; u += gridDim.x) {
        const int ct = u / NRT, rt = u % NRT;
        ALoad al; al.base = H + (size_t)rt * 256 * D;
#pragma unroll
        for (int i = 0; i < 4; ++i) al.row[i] = (unsigned)(((tid >> 3) + 64 * i) * D + 8 * (tid & 7));
        BLoad bl; const int col = ct * 256 + 4 * (tid & 63);
        bl.valid = col < INW; bl.ldb = INW; bl.base = W + (size_t)(8 * (tid >> 6)) * INW + (bl.valid ? col : 0);
        f32x16 acc[4][2];
        gemm_mainloop(lds, D / 64, al, bl, acc, tid);
        int cbase = ct * 256 + 64 * wc + r, rb0 = rt * 256 + 128 * wr + 4 * h;
        asm volatile("" : "+v"(cbase), "+v"(rb0));
#pragma unroll
        for (int mt = 0; mt < 4; ++mt)
#pragma unroll
            for (int nt = 0; nt < 2; ++nt) {
                const int cc = cbase + 32 * nt;
                if (cc < INW) {
#pragma unroll
                    for (int i = 0; i < 16; ++i) P[(size_t)(rb0 + 32 * mt + crow32(i, 0)) * INW + cc] = f2bf(acc[mt][nt][i]);
                }
            }
    }
}

DI void phase_outproj(const Params& p, lptr lds, int tid, int l) {
    const bf16_t* MIX = (const bf16_t*)(p.ws + WS_MIX);
    float* X = (float*)(p.ws + WS_X);
    float* SSQ = (float*)(p.ws + WS_SSQ);
    const float* mod = (const float*)(p.ws + WS_MOD);
    const float* W = p.w_out + (size_t)l * D * D;
    const int lane = tid & 63, w = tid >> 6, wr = w >> 2, wc = w & 3, r = lane & 31, h = lane >> 5;
    constexpr int NRT = NT / 256, NCT = D / 256;
    for (int u = blockIdx.x; u < NRT * NCT; u += gridDim.x) {
        const int ct = u / NRT, rt = u % NRT;
        ALoad al; al.base = MIX + (size_t)rt * 256 * D;
#pragma unroll
        for (int i = 0; i < 4; ++i) al.row[i] = (unsigned)(((tid >> 3) + 64 * i) * D + 8 * (tid & 7));
        BLoad bl; bl.valid = true; bl.ldb = D; bl.base = W + (size_t)(8 * (tid >> 6)) * D + ct * 256 + 4 * (tid & 63);
        f32x16 acc[4][2];
        gemm_mainloop(lds, D / 64, al, bl, acc, tid);
        const int sidx = rt == 0 ? 1 : 0;
        const float* g1 = mod + ((size_t)l * 2 + sidx) * 6 * D + 2 * D;
        const float* res = (l == 0) ? (rt == 0 ? p.ctx : p.x + (size_t)(rt * 256 - NCTX) * D) : X + (size_t)rt * 256 * D;
        float* dst = X + (size_t)rt * 256 * D;
        int c0 = ct * 256 + 64 * wc + r, rb0 = 128 * wr + 4 * h;
        asm volatile("" : "+v"(c0), "+v"(rb0));
        const float ga = g1[c0], gb = g1[c0 + 32];
#pragma unroll
        for (int mt = 0; mt < 4; ++mt)
#pragma unroll
            for (int i = 0; i < 16; ++i) {
                if ((i & 3) == 0) asm volatile("" ::: "memory");
                const int row = rb0 + 32 * mt + crow32(i, 0);
                const float xa = res[(size_t)row * D + c0] + ga * acc[mt][0][i], xb = res[(size_t)row * D + c0 + 32] + gb * acc[mt][1][i];
                dst[(size_t)row * D + c0] = xa; dst[(size_t)row * D + c0 + 32] = xb;
                float s = xa * xa + xb * xb;
                s += __shfl_xor(s, 1); s += __shfl_xor(s, 2); s += __shfl_xor(s, 4); s += __shfl_xor(s, 8); s += __shfl_xor(s, 16);
                if (r == 0) SSQ[(size_t)(rt * 256 + row) * 32 + ct * 4 + wc] = s;
            }
    }
}

DI void conv_unit(const Params& p, int tid, int l, int u) {
    const bf16_t* P = (const bf16_t*)(p.ws + WS_P);
    bf16_t* MIX = (bf16_t*)(p.ws + WS_MIX);
    const int ch = 8 * (tid & 63), rs = tid >> 6;
    float w0[8], w1[8], w2[8];
#pragma unroll
    for (int i = 0; i < 8; ++i) { w0[i] = p.conv_w[(size_t)(l * 3 + 0) * 512 + ch + i]; w1[i] = p.conv_w[(size_t)(l * 3 + 1) * 512 + ch + i]; w2[i] = p.conv_w[(size_t)(l * 3 + 2) * 512 + ch + i]; }
#pragma unroll
    for (int ps = 0; ps < 4; ++ps) {
        const int row = 32 * u + 8 * ps + rs;
        const bool pv = (row != 0 && row != NCTX), nv = (row != NCTX - 1 && row != NT - 1);
        float cb[8], a[8], b[8], o[8];
        unpack8(*(const u32x4*)(P + (size_t)row * INW + C_CB + ch), cb);
        unpack8(*(const u32x4*)(P + (size_t)row * INW + C_CC + ch), a); unpack8(*(const u32x4*)(P + (size_t)row * INW + C_CH + ch), b);
#pragma unroll
        for (int i = 0; i < 8; ++i) o[i] = w1[i] * (a[i] * b[i]);
        if (pv) {
            unpack8(*(const u32x4*)(P + (size_t)(row - 1) * INW + C_CC + ch), a); unpack8(*(const u32x4*)(P + (size_t)(row - 1) * INW + C_CH + ch), b);
#pragma unroll
            for (int i = 0; i < 8; ++i) o[i] += w0[i] * (a[i] * b[i]);
        }
        if (nv) {
            unpack8(*(const u32x4*)(P + (size_t)(row + 1) * INW + C_CC + ch), a); unpack8(*(const u32x4*)(P + (size_t)(row + 1) * INW + C_CH + ch), b);
#pragma unroll
            for (int i = 0; i < 8; ++i) o[i] += w2[i] * (a[i] * b[i]);
        }
#pragma unroll
        for (int i = 0; i < 8; ++i) o[i] *= cb[i];
        *(u32x4*)(MIX + (size_t)row * D + ch) = pack8(o);
    }
}

#define BUF(i) (lds + (i) * IMG)
DI void rw1_unit(const Params& p, lptr lds, int tid, int l, int d, int h, int c) {
    const int lane = tid & 63, w = tid >> 6, r16 = lane & 15, q4 = lane >> 4;
    const int tb = d == 0 ? c : (c < 4 ? 3 - c : 263 - c);
    const bf16_t* P = (const bf16_t*)(p.ws + WS_P);
    LAS float* LW = (LAS float*)BUF(9); LAS float* AA = LW + 64 * 65; LAS float* GL = (LAS float*)BUF(14);
    const int ld = l * 2 + d;
    {
        const int mt = w >> 1, tau = 16 * mt + r16, row = 64 * tb + (d ? 63 - tau : tau);
        bf16x8 aw[2], aa[2];
#pragma unroll
        for (int ks = 0; ks < 2; ++ks) {
            float f[8]; unpack8(*(const u32x4*)(P + (size_t)row * INW + C_WD + 64 * d + 32 * ks + 8 * q4), f);
#pragma unroll
            for (int j = 0; j < 8; ++j) f[j] = tanhf(f[j]);
            aw[ks] = as_frag(pack8(f));
            aa[ks] = as_frag(*(const u32x4*)(P + (size_t)row * INW + C_AD + 64 * d + 32 * ks + 8 * q4));
        }
        const u32x4* duf = (const u32x4*)(p.ws + WS_DUF) + (size_t)(ld * 12 + h) * 512;
        const u32x4* iuf = (const u32x4*)(p.ws + WS_IUF) + (size_t)(ld * 12 + h) * 512;
#pragma unroll
        for (int nn = 0; nn < 2; ++nn) {
            const int nt = 2 * (w & 1) + nn, j = 16 * nt + r16;
            f32x4 z = {0.f, 0.f, 0.f, 0.f}, a = {0.f, 0.f, 0.f, 0.f};
#pragma unroll
            for (int ks = 0; ks < 2; ++ks) { z = mfma16(aw[ks], as_frag(duf[(ks * 4 + nt) * 64 + lane]), z); a = mfma16(aa[ks], as_frag(iuf[(ks * 4 + nt) * 64 + lane]), a); }
            const float db = p.decay_base[(size_t)ld * 768 + 64 * h + j], ib = p.iclr_base[(size_t)ld * 768 + 64 * h + j];
#pragma unroll
            for (int jj = 0; jj < 4; ++jj) { const int t2 = 16 * mt + 4 * q4 + jj; LW[t2 * 65 + j] = -0.60653066f * sigmoidf_(z[jj] + db); AA[t2 * 65 + j] = sigmoidf_(a[jj] + ib); }
        }
    }
    __syncthreads();
    if (tid < 64) { float cs = 0.f; for (int t2 = 0; t2 < 64; ++t2) { cs += LW[t2 * 65 + tid]; LW[t2 * 65 + tid] = cs; } }
    __syncthreads();
    {
        const int tau = tid >> 3, jc = tid & 7, row = 64 * tb + (d ? 63 - tau : tau);
        const size_t pb = (size_t)row * INW + 64 * h + 8 * jc;
        float r8[8], k8[8];
        unpack8(*(const u32x4*)(P + pb + C_RR), r8); unpack8(*(const u32x4*)(P + pb + C_RK), k8);
        const u32x4 vraw = *(const u32x4*)(P + pb + C_RV);
        float kkv[8], ss = 0.f;
#pragma unroll
        for (int i = 0; i < 8; ++i) { kkv[i] = k8[i] * p.k_k[(size_t)l * 768 + 64 * h + 8 * jc + i]; ss += kkv[i] * kkv[i]; }
        ss += __shfl_xor(ss, 1); ss += __shfl_xor(ss, 2); ss += __shfl_xor(ss, 4);
        const float inv = 1.0f / fmaxf(sqrtf(ss), 1e-12f);
        float bon = 0.f, At[8], Rt[8], Bt[8], Kt[8];
#pragma unroll
        for (int i = 0; i < 8; ++i) {
            const float lc = LW[tau * 65 + 8 * jc + i], le = tau ? LW[(tau - 1) * 65 + 8 * jc + i] : 0.f, a = AA[tau * 65 + 8 * jc + i];
            const float kkn = kkv[i] * inv, kd = k8[i] * (1.0f + (a - 1.0f) * p.k_a[(size_t)l * 768 + 64 * h + 8 * jc + i]), b = kkn * a;
            bon += r8[i] * kd * p.r_k[(size_t)(l * 12 + h) * 64 + 8 * jc + i];
            const float en = __expf(-lc);
            At[i] = kkn * __expf(le); Rt[i] = r8[i] * __expf(lc); Bt[i] = b * en; Kt[i] = kd * en;
            if (tau == 63) GL[8 * jc + i] = __expf(lc);
        }
        bon += __shfl_xor(bon, 1); bon += __shfl_xor(bon, 2); bon += __shfl_xor(bon, 4);
        if (jc == 0) ((float*)(p.ws + WS_BONUS))[((size_t)d * NT + row) * 12 + h] = bon;
        const int o = (tau * SS + 8 * jc) * 2;
        *(LAS u32x4*)(BUF(4) + o) = pack8(At); *(LAS u32x4*)(BUF(5) + o) = pack8(Rt); *(LAS u32x4*)(BUF(6) + o) = pack8(Bt); *(LAS u32x4*)(BUF(7) + o) = pack8(Kt);
        *(LAS u32x4*)(BUF(8) + o) = vraw;
    }
    __syncthreads();
    mm64<false, false>(BUF(6), BUF(4), w, lane, [&](int mt, int nt, const f32x4& acc) {
        f32x4 n, t;
#pragma unroll
        for (int jj = 0; jj < 4; ++jj) { const int s = 16 * mt + 4 * q4 + jj, ta = 16 * nt + r16; n[jj] = s < ta ? acc[jj] : 0.f; t[jj] = (s == ta ? 1.f : 0.f) - n[jj]; }
        img_store(BUF(0), mt, nt, lane, n); img_store(BUF(2), mt, nt, lane, t); });
    mm64<false, false>(BUF(7), BUF(4), w, lane, [&](int mt, int nt, const f32x4& acc) {
        f32x4 n;
#pragma unroll
        for (int jj = 0; jj < 4; ++jj) { const int s = 16 * mt + 4 * q4 + jj, ta = 16 * nt + r16; n[jj] = s < ta ? acc[jj] : 0.f; }
        img_store(BUF(9), mt, nt, lane, n); });
    mm64<false, false>(BUF(6), BUF(5), w, lane, [&](int mt, int nt, const f32x4& acc) {
        f32x4 n;
#pragma unroll
        for (int jj = 0; jj < 4; ++jj) { const int s = 16 * mt + 4 * q4 + jj, ta = 16 * nt + r16; n[jj] = s <= ta ? acc[jj] : 0.f; }
        img_store(BUF(10), mt, nt, lane, n); });
    mm64<false, false>(BUF(7), BUF(5), w, lane, [&](int mt, int nt, const f32x4& acc) {
        f32x4 n;
#pragma unroll
        for (int jj = 0; jj < 4; ++jj) { const int s = 16 * mt + 4 * q4 + jj, ta = 16 * nt + r16; n[jj] = s <= ta ? acc[jj] : 0.f; }
        img_store(BUF(11), mt, nt, lane, n); });
    __syncthreads();
#define NSQ(src, dst) mm64<false, true>(BUF(src), BUF(src), w, lane, [&](int mt, int nt, const f32x4& acc) { img_store(BUF(dst), mt, nt, lane, acc); })
#define TMUL(ta, np, dst) mm64<false, true>(BUF(ta), BUF(np), w, lane, [&](int mt, int nt, const f32x4& acc) { f32x4 v; \
        _Pragma("unroll") for (int jj = 0; jj < 4; ++jj) v[jj] = acc[jj] + img_ld(BUF(ta), 16 * mt + 4 * q4 + jj, 16 * nt + r16); img_store(BUF(dst), mt, nt, lane, v); })
    NSQ(0, 1); __syncthreads();
    NSQ(1, 0); TMUL(2, 1, 3); __syncthreads();
    NSQ(0, 1); TMUL(3, 0, 2); __syncthreads();
    NSQ(1, 0); TMUL(2, 1, 3); __syncthreads();
    NSQ(0, 1); TMUL(3, 0, 2); __syncthreads();
    TMUL(2, 1, 3); __syncthreads();
    mm64<true, true>(BUF(4), BUF(3), w, lane, [&](int mt, int nt, const f32x4& acc) { img_store(BUF(12), mt, nt, lane, acc); });
    mm64<false, true>(BUF(9), BUF(3), w, lane, [&](int mt, int nt, const f32x4& acc) { img_store(BUF(13), mt, nt, lane, acc); });
    __syncthreads();
    mm64<false, true>(BUF(12), BUF(6), w, lane, [&](int mt, int nt, const f32x4& acc) {
        const float gl = GL[16 * nt + r16]; f32x4 v;
#pragma unroll
        for (int jj = 0; jj < 4; ++jj) v[jj] = ((16 * mt + 4 * q4 + jj == 16 * nt + r16 ? 1.f : 0.f) - acc[jj]) * gl;
        img_store_t(BUF(0), mt, nt, lane, v); });
    mm64<true, false>(BUF(10), BUF(12), w, lane, [&](int mt, int nt, const f32x4& acc) {
        f32x4 v;
#pragma unroll
        for (int jj = 0; jj < 4; ++jj) v[jj] = img_ld(BUF(5), 16 * mt + 4 * q4 + jj, 16 * nt + r16) - acc[jj];
        img_store(BUF(1), mt, nt, lane, v); });
    mm64<false, true>(BUF(13), BUF(10), w, lane, [&](int mt, int nt, const f32x4& acc) {
        f32x4 v;
#pragma unroll
        for (int jj = 0; jj < 4; ++jj) v[jj] = img_ld(BUF(11), 16 * mt + 4 * q4 + jj, 16 * nt + r16) - acc[jj];
        img_store(BUF(2), mt, nt, lane, v); });
    mm64<false, true>(BUF(13), BUF(6), w, lane, [&](int mt, int nt, const f32x4& acc) {
        const float gl = GL[16 * nt + r16]; f32x4 v;
#pragma unroll
        for (int jj = 0; jj < 4; ++jj) v[jj] = (img_ld(BUF(7), 16 * mt + 4 * q4 + jj, 16 * nt + r16) - acc[jj]) * gl;
        img_store(BUF(3), mt, nt, lane, v); });
    __syncthreads();
    mm64<true, true>(BUF(2), BUF(8), w, lane, [&](int mt, int nt, const f32x4& acc) { img_store(BUF(4), mt, nt, lane, acc); });
    mm64<true, true>(BUF(8), BUF(3), w, lane, [&](int mt, int nt, const f32x4& acc) { img_store(BUF(5), mt, nt, lane, acc); });
    __syncthreads();
    {
        bf16_t* dst = (bf16_t*)(p.ws + WS_RW1) + ((size_t)((d * 12 + h) * NCHUNK + c) * 4) * 4096;
        const int row = tid >> 3, ch = tid & 7, so = (row * SS + 8 * ch) * 2, go = row * 64 + 8 * ch;
        *(u32x4*)(dst + go) = *(LAS u32x4*)(BUF(0) + so);
        *(u32x4*)(dst + 4096 + go) = *(LAS u32x4*)(BUF(1) + so);
        *(u32x4*)(dst + 2 * 4096 + go) = *(LAS u32x4*)(BUF(4) + so);
        *(u32x4*)(dst + 3 * 4096 + go) = *(LAS u32x4*)(BUF(5) + so);
    }
#undef NSQ
#undef TMUL
}

DI void rw2_scan(const Params& p, lptr lds, int tid, int d, int h) {
    const int lane = tid & 63, w = tid >> 6, r16 = lane & 15, q4 = lane >> 4, mt = w >> 1;
    const bf16_t* RW = (const bf16_t*)(p.ws + WS_RW1) + (size_t)((d * 12 + h) * NCHUNK) * 4 * 4096;
    bf16_t* SB = (bf16_t*)(p.ws + WS_SBUF) + (size_t)((d * 12 + h) * NCHUNK) * 4096;
    const int row = tid >> 3, ch = tid & 7, so = (row * SS + 8 * ch) * 2, go = row * 64 + 8 * ch;
    *(LAS u32x4*)(BUF(0) + so) = (u32x4){0u, 0u, 0u, 0u};
    u32x4 pa[2]; u32x2 gg[2];
#pragma unroll
    for (int ks = 0; ks < 2; ++ks) pa[ks] = *(const u32x4*)(RW + (16 * mt + r16) * 64 + 32 * ks + 8 * q4);
#pragma unroll
    for (int nn = 0; nn < 2; ++nn) gg[nn] = *(const u32x2*)(RW + 3 * 4096 + (16 * (2 * (w & 1) + nn) + r16) * 64 + 16 * mt + 4 * q4);
    __syncthreads();
    for (int c = 0; c < NCHUNK; ++c) {
        lptr cur = BUF(c & 1), nxt = BUF((c & 1) ^ 1);
        *(u32x4*)(SB + (size_t)c * 4096 + go) = *(LAS u32x4*)(cur + so);
        u32x4 npa[2]; u32x2 ngg[2];
        const bf16_t* RN = RW + (size_t)(c + 1 < NCHUNK ? c + 1 : c) * 4 * 4096;
#pragma unroll
        for (int ks = 0; ks < 2; ++ks) npa[ks] = *(const u32x4*)(RN + (16 * mt + r16) * 64 + 32 * ks + 8 * q4);
#pragma unroll
        for (int nn = 0; nn < 2; ++nn) ngg[nn] = *(const u32x2*)(RN + 3 * 4096 + (16 * (2 * (w & 1) + nn) + r16) * 64 + 16 * mt + 4 * q4);
#pragma unroll
        for (int nn = 0; nn < 2; ++nn) {
            const int nt = 2 * (w & 1) + nn;
            f32x4 acc = {bflo(gg[nn].x), bfhi(gg[nn].x), bflo(gg[nn].y), bfhi(gg[nn].y)};
            acc = mfma16(as_frag(pa[0]), frag_n(cur, nt, 0, lane), acc);
            acc = mfma16(as_frag(pa[1]), frag_n(cur, nt, 1, lane), acc);
            u32x2 o; o.x = pk2(acc[0], acc[1]); o.y = pk2(acc[2], acc[3]);
            *(LAS u32x2*)(nxt + ((16 * nt + r16) * SS + 16 * mt + 4 * q4) * 2) = o;
        }
        pa[0] = npa[0]; pa[1] = npa[1]; gg[0] = ngg[0]; gg[1] = ngg[1];
        __syncthreads();
    }
}

DI void rw3_task(const Params& p, int l, int tb, int h, int ns, int lane) {
    const int r16 = lane & 15, q4 = lane >> 4;
    const int cf = tb, cb = tb < 4 ? 3 - tb : 263 - tb;
    const bf16_t* RWf = (const bf16_t*)(p.ws + WS_RW1) + (size_t)((0 * 12 + h) * NCHUNK + cf) * 4 * 4096;
    const bf16_t* RWb = (const bf16_t*)(p.ws + WS_RW1) + (size_t)((1 * 12 + h) * NCHUNK + cb) * 4 * 4096;
    const bf16_t* Sf = (const bf16_t*)(p.ws + WS_SBUF) + (size_t)((0 * 12 + h) * NCHUNK + cf) * 4096;
    const bf16_t* Sb = (const bf16_t*)(p.ws + WS_SBUF) + (size_t)((1 * 12 + h) * NCHUNK + cb) * 4096;
    const bf16_t* P = (const bf16_t*)(p.ws + WS_P);
    const int tf = 16 * ns + r16, tbk = 63 - tf, row = 64 * tb + tf;
    bf16x8 qf[2], qb[2], sg[4];
#pragma unroll
    for (int ks = 0; ks < 2; ++ks) { qf[ks] = as_frag(*(const u32x4*)(RWf + 4096 + tf * 64 + 32 * ks + 8 * q4)); qb[ks] = as_frag(*(const u32x4*)(RWb + 4096 + tbk * 64 + 32 * ks + 8 * q4)); }
#pragma unroll
    for (int ks = 0; ks < 4; ++ks) {
        float f[8]; unpack8(*(const u32x4*)(P + (size_t)row * INW + C_GD + 32 * ks + 8 * q4), f);
#pragma unroll
        for (int j = 0; j < 8; ++j) f[j] = sigmoidf_(f[j]);
        sg[ks] = as_frag(pack8(f));
    }
    const u32x4* guf = (const u32x4*)(p.ws + WS_GUF) + (size_t)(l * 12 + h) * 1024;
    f32x4 y[4], gt[4];
#pragma unroll
    for (int mt = 0; mt < 4; ++mt) {
        const u32x2 yf = *(const u32x2*)(RWf + 2 * 4096 + tf * 64 + 16 * mt + 4 * q4), yb = *(const u32x2*)(RWb + 2 * 4096 + tbk * 64 + 16 * mt + 4 * q4);
        f32x4 acc = {bflo(yf.x) + bflo(yb.x), bfhi(yf.x) + bfhi(yb.x), bflo(yf.y) + bflo(yb.y), bfhi(yf.y) + bfhi(yb.y)};
#pragma unroll
        for (int ks = 0; ks < 2; ++ks) {
            acc = mfma16(as_frag(*(const u32x4*)(Sf + (16 * mt + r16) * 64 + 32 * ks + 8 * q4)), qf[ks], acc);
            acc = mfma16(as_frag(*(const u32x4*)(Sb + (16 * mt + r16) * 64 + 32 * ks + 8 * q4)), qb[ks], acc);
        }
        y[mt] = acc;
        f32x4 g = {0.f, 0.f, 0.f, 0.f};
#pragma unroll
        for (int ks = 0; ks < 4; ++ks) g = mfma16(as_frag(guf[(ks * 4 + mt) * 64 + lane]), sg[ks], g);
        gt[mt] = g;
    }
    float s = 0.f;
#pragma unroll
    for (int mt = 0; mt < 4; ++mt) s += (y[mt][0] + y[mt][1]) + (y[mt][2] + y[mt][3]);
    s += __shfl_xor(s, 16); s += __shfl_xor(s, 32);
    const float mu = s * (1.0f / 64.0f);
    float q = 0.f;
#pragma unroll
    for (int mt = 0; mt < 4; ++mt)
#pragma unroll
        for (int jj = 0; jj < 4; ++jj) { const float dlt = y[mt][jj] - mu; q += dlt * dlt; }
    q += __shfl_xor(q, 16); q += __shfl_xor(q, 32);
    const float rs = rsqrtf(q * (1.0f / 64.0f) + 64e-5f);
    const float* BO = (const float*)(p.ws + WS_BONUS);
    const float bonus = BO[((size_t)0 * NT + row) * 12 + h] + BO[((size_t)1 * NT + row) * 12 + h];
    bf16_t* MIX = (bf16_t*)(p.ws + WS_MIX);
#pragma unroll
    for (int mt = 0; mt < 4; ++mt) {
        const int i0 = 64 * h + 16 * mt + 4 * q4;
        const f32x4 lw = *(const f32x4*)(p.lnx_w + (size_t)l * 768 + i0), lb = *(const f32x4*)(p.lnx_b + (size_t)l * 768 + i0);
        const u32x2 vr = *(const u32x2*)(P + (size_t)row * INW + C_RV + i0);
        const f32x4 vv = {bflo(vr.x), bfhi(vr.x), bflo(vr.y), bfhi(vr.y)};
        const f32x4 o = ((y[mt] - mu) * rs * lw + lb + vv * bonus) * gt[mt];
        u32x2 ov; ov.x = pk2(o[0], o[1]); ov.y = pk2(o[2], o[3]);
        *(u32x2*)(MIX + (size_t)row * D + 1280 + i0) = ov;
    }
}

DI void rope8(const f32x2* tab, int pos, int c, const float (&own)[8], const float (&par)[8], float (&out)[8]) {
    const int idx = (c >> 2) ? 256 + (pos & 63) : (pos >> 6);
    const f32x2* t = tab + idx * 16 + 8 * (c & 1);
    const bool second = (c >> 1) & 1;
#pragma unroll
    for (int e = 0; e < 8; ++e) { const f32x2 cs = t[e]; out[e] = second ? par[e] * cs.y + own[e] * cs.x : own[e] * cs.x - par[e] * cs.y; }
}
DI void attn_unit(const Params& p, lptr lds, int tid, int l, int u) {
    const int lane = tid & 63, w = tid >> 6, r16 = lane & 15, q4 = lane >> 4;
    const bool lat = u < 512;
    const int uu = lat ? u : u - 512, qb = uu >> 2, g = uu & 3;
    const int qrow = (lat ? NCTX : 0) + 128 * qb + 16 * w + r16, qpos = 128 * qb + 16 * w + r16;
    const bf16_t* P = (const bf16_t*)(p.ws + WS_P);
    const f32x2* tab = (const f32x2*)(p.ws + WS_ROPE);
    lptr KI = BUF(0), VI = BUF(1);
    bf16x8 qf[3][2]; float m[3], ls[3]; f32x4 O[3][4];
#pragma unroll
    for (int hh = 0; hh < 3; ++hh) {
        const int head = 3 * g + hh;
#pragma unroll
        for (int ks = 0; ks < 2; ++ks) {
            const int c = 4 * ks + q4;
            float own[8], par[8], o[8];
            unpack8(*(const u32x4*)(P + (size_t)qrow * INW + C_Q + 64 * head + 8 * c), own);
            if (lat) { unpack8(*(const u32x4*)(P + (size_t)qrow * INW + C_Q + 64 * head + 8 * (c ^ 2)), par); rope8(tab, qpos, c, own, par, o); }
            else {
#pragma unroll
                for (int e = 0; e < 8; ++e) o[e] = own[e];
            }
#pragma unroll
            for (int e = 0; e < 8; ++e) o[e] *= 0.125f;
            qf[hh][ks] = as_frag(pack8(o));
        }
        m[hh] = p.sinks[(size_t)l * 12 + head]; ls[hh] = 1.0f;
#pragma unroll
        for (int dt = 0; dt < 4; ++dt) O[hh][dt] = (f32x4){0.f, 0.f, 0.f, 0.f};
    }
    const int ntl = lat ? 10 : 4;
    for (int ti = 0; ti < ntl; ++ti) {
        const bool loc = ti >= 4;
        const int kpos0 = loc ? 128 * (qb - 1) + 64 * (ti - 4) : 0;
        if (loc && (kpos0 < 0 || kpos0 >= NLAT)) continue;
        const int krow0 = loc ? NCTX + kpos0 : 64 * ti;
        {
            const int key = tid >> 3, c = tid & 7; const size_t rb = (size_t)(krow0 + key) * INW;
            float own[8], par[8], o[8];
            const u32x4 kraw = *(const u32x4*)(P + rb + C_K + 64 * g + 8 * c);
            u32x4 kv = kraw;
            if (loc) { unpack8(kraw, own); unpack8(*(const u32x4*)(P + rb + C_K + 64 * g + 8 * (c ^ 2)), par); rope8(tab, kpos0 + key, c, own, par, o); kv = pack8(o); }
            *(LAS u32x4*)(KI + (key * SS + 8 * c) * 2) = kv;
            *(LAS u32x4*)(VI + (key * SS + 8 * c) * 2) = *(const u32x4*)(P + rb + C_V + 64 * g + 8 * c);
        }
        __syncthreads();
#pragma unroll
        for (int hh = 0; hh < 3; ++hh) {
            f32x4 st[4];
            float tmax = -3.0e38f;
#pragma unroll
            for (int mt = 0; mt < 4; ++mt) {
                f32x4 acc = {0.f, 0.f, 0.f, 0.f};
                acc = mfma16(frag_n(KI, mt, 0, lane), qf[hh][0], acc);
                acc = mfma16(frag_n(KI, mt, 1, lane), qf[hh][1], acc);
                if (loc) {
#pragma unroll
                    for (int jj = 0; jj < 4; ++jj) { const int dl = kpos0 + 16 * mt + 4 * q4 + jj - qpos; if (dl < -128 || dl > 128) acc[jj] = -1.0e30f; }
                }
                st[mt] = acc;
                tmax = fmaxf(tmax, fmaxf(fmaxf(acc[0], acc[1]), fmaxf(acc[2], acc[3])));
            }
            tmax = fmaxf(tmax, __shfl_xor(tmax, 16)); tmax = fmaxf(tmax, __shfl_xor(tmax, 32));
            const float mn = fmaxf(m[hh], tmax), alpha = __expf(m[hh] - mn);
            float psum = 0.f;
#pragma unroll
            for (int mt = 0; mt < 4; ++mt)
#pragma unroll
                for (int jj = 0; jj < 4; ++jj) { const float e = __expf(st[mt][jj] - mn); st[mt][jj] = e; psum += e; }
            psum += __shfl_xor(psum, 16); psum += __shfl_xor(psum, 32);
            ls[hh] = ls[hh] * alpha + psum; m[hh] = mn;
            bf16x8 pf[2];
#pragma unroll
            for (int k2 = 0; k2 < 2; ++k2) {
                u32x4 pv; pv.x = pk2(st[2 * k2][0], st[2 * k2][1]); pv.y = pk2(st[2 * k2][2], st[2 * k2][3]); pv.z = pk2(st[2 * k2 + 1][0], st[2 * k2 + 1][1]); pv.w = pk2(st[2 * k2 + 1][2], st[2 * k2 + 1][3]);
                pf[k2] = as_frag(pv);
            }
#pragma unroll
            for (int dt = 0; dt < 4; ++dt) {
                f32x4 o = O[hh][dt] * alpha;
#pragma unroll
                for (int k2 = 0; k2 < 2; ++k2) {
                    lptr a0 = VI + ((32 * k2 + 4 * q4 + ((lane & 15) >> 2)) * SS + 16 * dt + 4 * (lane & 3)) * 2;
                    o = mfma16(lds_tr_pair(a0, a0 + 16 * SS * 2), pf[k2], o);
                }
                O[hh][dt] = o;
            }
        }
        __syncthreads();
    }
    bf16_t* MIX = (bf16_t*)(p.ws + WS_MIX);
#pragma unroll
    for (int hh = 0; hh < 3; ++hh) {
        const float il = 1.0f / ls[hh];
#pragma unroll
        for (int dt = 0; dt < 4; ++dt) {
            const f32x4 o = O[hh][dt] * il;
            u32x2 ov; ov.x = pk2(o[0], o[1]); ov.y = pk2(o[2], o[3]);
            *(u32x2*)(MIX + (size_t)qrow * D + 512 + 64 * (3 * g + hh) + 16 * dt + 4 * q4) = ov;
        }
    }
}

DI void phase_norm2_router(const Params& p, lptr lds, int tid, int l) {
    const int lane = tid & 63, w = tid >> 6, r16 = lane & 15, q4 = lane >> 4;
    const float* X = (const float*)(p.ws + WS_X);
    const float* SSQ = (const float*)(p.ws + WS_SSQ);
    const float* mod = (const float*)(p.ws + WS_MOD);
    bf16_t* H = (bf16_t*)(p.ws + WS_H);
    const u32x4* wf = (const u32x4*)(p.ws + WS_WFRAG);
    unsigned* cnt = (unsigned*)(p.ws + WS_CTL) + CW_CNT + 32 * l;
    int* list = (int*)(p.ws + WS_LIST);
    LAS float* sc = (LAS float*)(lds + w * 2048);
    for (int tile = blockIdx.x * 8 + w; tile < NT / 16; tile += gridDim.x * 8) {
        if (l == 1 && tile < NCTX / 16) continue;
        const int row = 16 * tile + r16, sidx = (16 * tile < NCTX) ? 1 : 0;
        float ssq = 0.f;
        { const f32x4 a = *(const f32x4*)(SSQ + (size_t)row * 32 + 8 * q4), b = *(const f32x4*)(SSQ + (size_t)row * 32 + 8 * q4 + 4); ssq = (a[0] + a[1]) + (a[2] + a[3]) + (b[0] + b[1]) + (b[2] + b[3]); }
        ssq += __shfl_xor(ssq, 16); ssq += __shfl_xor(ssq, 32);
        const float rstd = rsqrtf(ssq * (1.0f / D) + 1e-6f);
        const float* ng = p.norm2_g + (size_t)l * D;
        const float* sh = mod + ((size_t)l * 2 + sidx) * 6 * D + 3 * D, *scl = sh + D;
        f32x4 acc[2] = {{0.f, 0.f, 0.f, 0.f}, {0.f, 0.f, 0.f, 0.f}};
#pragma unroll 2
        for (int s = 0; s < 64; ++s) {
            const int col = 32 * s + 8 * q4;
            float hv[8], hi[8], lo[8];
#pragma unroll
            for (int hf = 0; hf < 2; ++hf) {
                const f32x4 xv = *(const f32x4*)(X + (size_t)row * D + col + 4 * hf), gv = *(const f32x4*)(ng + col + 4 * hf), sv = *(const f32x4*)(scl + col + 4 * hf), bv = *(const f32x4*)(sh + col + 4 * hf);
                const f32x4 t = xv * rstd * gv * (sv + 1.0f) + bv;
                hv[4 * hf] = t[0]; hv[4 * hf + 1] = t[1]; hv[4 * hf + 2] = t[2]; hv[4 * hf + 3] = t[3];
            }
            const u32x4 hp = pack8(hv);
            *(u32x4*)(H + (size_t)row * D + col) = hp;
            unpack8(hp, hi);
#pragma unroll
            for (int j = 0; j < 8; ++j) lo[j] = hv[j] - hi[j];
            const bf16x8 ah = as_frag(hp), alo = as_frag(pack8(lo));
#pragma unroll
            for (int nt = 0; nt < 2; ++nt) {
                const bf16x8 wh = as_frag(wf[(s * 2 + nt) * 64 + lane]), wl = as_frag(wf[8192 + (s * 2 + nt) * 64 + lane]);
                acc[nt] = mfma16(ah, wh, acc[nt]); acc[nt] = mfma16(ah, wl, acc[nt]); acc[nt] = mfma16(alo, wh, acc[nt]);
            }
        }
#pragma unroll
        for (int nt = 0; nt < 2; ++nt)
#pragma unroll
            for (int jj = 0; jj < 4; ++jj) sc[(4 * q4 + jj) * 32 + 16 * nt + r16] = sigmoidf_(acc[nt][jj]);
        __builtin_amdgcn_wave_barrier();
        asm volatile("s_waitcnt lgkmcnt(0)" ::: "memory");
        if (lane < 16) {
            const int rr = 16 * tile + lane;
            int bg = 0; float bgs = -3.0e38f;
            for (int g = 0; g < 4; ++g) {
                float m1 = -3.0e38f, m2 = -3.0e38f;
                for (int e = 8 * g; e < 8 * g + 8; ++e) { const float v = sc[lane * 32 + e] + p.router_b[e]; if (v > m1) { m2 = m1; m1 = v; } else if (v > m2) m2 = v; }
                const float gs = m1 + m2;
                if (gs > bgs) { bgs = gs; bg = g; }
            }
            int i0 = 8 * bg, i1 = 8 * bg; float v0 = -3.0e38f, v1 = -3.0e38f;
            for (int e = 8 * bg; e < 8 * bg + 8; ++e) { const float v = sc[lane * 32 + e] + p.router_b[e]; if (v > v0) { v1 = v0; i1 = i0; v0 = v; i0 = e; } else if (v > v1) { v1 = v; i1 = e; } }
            const float g0 = sc[lane * 32 + i0], g1 = sc[lane * 32 + i1], gi = 1.0f / (g0 + g1);
            const int s0 = (int)atomicAdd(cnt + i0, 1u), s1 = (int)atomicAdd(cnt + i1, 1u);
            list[(size_t)i0 * NT + s0] = rr; list[(size_t)i1 * NT + s1] = rr;
            ((int4*)(p.ws + WS_TI))[rr] = make_int4(i0 | (i1 << 8), s0, s1, 0);
            ((f32x2*)(p.ws + WS_TW))[rr] = (f32x2){g0 * gi, g1 * gi};
        }
        __builtin_amdgcn_wave_barrier();
    }
}

DI void moe_tables(const Params& p, lptr lds, int tid, int l) {
    LAS int* tbs = (LAS int*)(lds + LDS_XB + 16);
    const unsigned* cnt = (const unsigned*)(p.ws + WS_CTL) + CW_CNT + 32 * l;
    if (tid == 0) { int acc = 0; for (int e = 0; e < NE; ++e) { tbs[e] = acc; acc += (int)((cnt[e] + 255u) >> 8); } tbs[NE] = acc; }
    __syncthreads();
}
DI void phase_moe1(const Params& p, lptr lds, int tid, int l) {
    moe_tables(p, lds, tid, l);
    LAS int* tbs = (LAS int*)(lds + LDS_XB + 16);
    const unsigned* cnt = (const unsigned*)(p.ws + WS_CTL) + CW_CNT + 32 * l;
    const int* list = (const int*)(p.ws + WS_LIST);
    const bf16_t* H = (const bf16_t*)(p.ws + WS_H);
    bf16_t* ACT = (bf16_t*)(p.ws + WS_ACT);
    const int lane = tid & 63, w = tid >> 6, wr = w >> 2, wc = w & 3, r = lane & 31, h = lane >> 5;
    const int total = tbs[NE] * 6;
    for (int u = blockIdx.x; u < total; u += gridDim.x) {
        int e = 0;
        while (e < NE - 1 && tbs[e + 1] * 6 <= u) ++e;
        const int te = tbs[e + 1] - tbs[e], ue = u - 6 * tbs[e], ntile = ue / te, mtile = ue % te, ce = (int)cnt[e];
        ALoad al; al.base = H;
#pragma unroll
        for (int i = 0; i < 4; ++i) { const int idx = 256 * mtile + (tid >> 3) + 64 * i; const int tok = idx < ce ? list[(size_t)e * NT + idx] : 0; al.row[i] = (unsigned)(tok * D + 8 * (tid & 7)); }
        BLoad bl; const int nb = tid & 63;
        bl.valid = true; bl.ldb = DE;
        bl.base = (((nb >> 3) & 1) ? p.e_up : p.e_gate) + ((size_t)(l * NE + e) * D + 8 * (tid >> 6)) * DE + 128 * ntile + 32 * (nb >> 4) + 4 * (nb & 7);
        f32x16 acc[4][2];
        gemm_mainloop(lds, D / 64, al, bl, acc, tid);
        int arow0 = (tbs[e] + mtile) * 256 + 128 * wr + 4 * h;
        int colo = 128 * ntile + 32 * wc + r;
        asm volatile("" : "+v"(colo), "+v"(arow0));
#pragma unroll
        for (int mt = 0; mt < 4; ++mt)
#pragma unroll
            for (int i = 0; i < 16; ++i) {
                const float gv = acc[mt][0][i], uv = acc[mt][1][i];
                ACT[(size_t)(arow0 + 32 * mt + crow32(i, 0)) * DE + colo] = f2bf(gv * sigmoidf_(gv) * uv);
            }
    }
}
DI void phase_moe2(const Params& p, lptr lds, int tid, int l) {
    moe_tables(p, lds, tid, l);
    LAS int* tbs = (LAS int*)(lds + LDS_XB + 16);
    const bf16_t* ACT = (const bf16_t*)(p.ws + WS_ACT);
    bf16_t* YB = (bf16_t*)(p.ws + WS_YB);
    const int lane = tid & 63, w = tid >> 6, wr = w >> 2, wc = w & 3, r = lane & 31, h = lane >> 5;
    const int total = tbs[NE] * 8;
    for (int u = blockIdx.x; u < total; u += gridDim.x) {
        int e = 0;
        while (e < NE - 1 && tbs[e + 1] * 8 <= u) ++e;
        const int te = tbs[e + 1] - tbs[e], ue = u - 8 * tbs[e], ntile = ue / te, mtile = ue % te;
        const size_t arow0 = (size_t)(tbs[e] + mtile) * 256;
        ALoad al; al.base = ACT + arow0 * DE;
#pragma unroll
        for (int i = 0; i < 4; ++i) al.row[i] = (unsigned)(((tid >> 3) + 64 * i) * DE + 8 * (tid & 7));
        BLoad bl; bl.valid = true; bl.ldb = D;
        bl.base = p.e_down + ((size_t)(l * NE + e) * DE + 8 * (tid >> 6)) * D + 256 * ntile + 4 * (tid & 63);
        f32x16 acc[4][2];
        gemm_mainloop(lds, DE / 64, al, bl, acc, tid);
        int cb2 = 256 * ntile + 64 * wc + r, rb2 = (int)arow0 + 128 * wr + 4 * h;
        asm volatile("" : "+v"(cb2), "+v"(rb2));
#pragma unroll
        for (int mt = 0; mt < 4; ++mt)
#pragma unroll
            for (int nt = 0; nt < 2; ++nt)
#pragma unroll
                for (int i = 0; i < 16; ++i) YB[(size_t)(rb2 + 32 * mt + crow32(i, 0)) * D + cb2 + 32 * nt] = f2bf(acc[mt][nt][i]);
    }
}

constexpr int NPHASE = 20;
__global__ void __launch_bounds__(NTHREADS, 2) mk_fwd(Params p) {
    extern __shared__ __attribute__((aligned(16))) unsigned char lds_raw[];
    lptr lds = (lptr)lds_raw;
    const int tid = threadIdx.x;
    if (tid < 4) ((LAS unsigned*)(lds + LDS_XB))[tid] = 0u;
    __syncthreads();
    XcdBarrier bar; bar.bar = (unsigned*)(p.ws + WS_CTL) + CW_BAR; bar.x = 0; bar.st = nullptr;
#if !MK_PER_PHASE
    bar = xcd_barrier_post((unsigned*)(p.ws + WS_CTL) + CW_BAR, (volatile LAS unsigned*)(lds + LDS_XB));
#endif
    const int lo = p.ph_lo, hi = p.ph_hi;
#define IN(k) (lo <= (k) && (k) < hi)
#if MK_PER_PHASE
#define SEAM(k) do { } while (0)
#else
#define SEAM(k) do { if (IN((k) + 1)) xcd_barrier(bar); } while (0)
#endif
    if (IN(0)) { phase_ada(p, lds, tid); SEAM(0); }
#define LAYER(l, base) \
    if (IN(base + 0)) { if (l == 0) phase_norm1<0>(p, lds, tid); else phase_norm1<1>(p, lds, tid); SEAM(base + 0); } \
    if (IN(base + 1)) { phase_inproj(p, lds, tid, l); SEAM(base + 1); } \
    if (IN(base + 2)) { \
        for (int u = blockIdx.x; u < NT / 32; u += gridDim.x) conv_unit(p, tid, l, u); \
        for (int u = blockIdx.x; u < 2 * 12 * NCHUNK; u += gridDim.x) { const int c = u % NCHUNK, dh = u / NCHUNK; rw1_unit(p, lds, tid, l, dh / 12, dh % 12, c); } \
        SEAM(base + 2); } \
    if (IN(base + 3)) { \
        if (blockIdx.x < 24) rw2_scan(p, lds, tid, blockIdx.x / 12, blockIdx.x % 12); \
        else { const int na = (l == 0) ? 520 : 512; for (int u = blockIdx.x - 24; u < na; u += gridDim.x - 24) attn_unit(p, lds, tid, l, u); } \
        SEAM(base + 3); } \
    if (IN(base + 4)) { \
        const int t0 = (l == 0) ? 0 : 4 * 12 * 4; \
        for (int t = t0 + blockIdx.x * 8 + (tid >> 6); t < NCHUNK * 12 * 4; t += gridDim.x * 8) rw3_task(p, l, t / 48, (t % 48) >> 2, t & 3, tid & 63); \
        SEAM(base + 4); } \
    if (IN(base + 5)) { phase_outproj(p, lds, tid, l); SEAM(base + 5); } \
    if (IN(base + 6)) { phase_norm2_router(p, lds, tid, l); SEAM(base + 6); } \
    if (IN(base + 7)) { phase_moe1(p, lds, tid, l); SEAM(base + 7); } \
    if (IN(base + 8)) { phase_moe2(p, lds, tid, l); SEAM(base + 8); }
    LAYER(0, 1)
    LAYER(1, 10)
    if (IN(19)) phase_norm1<2>(p, lds, tid);
#undef LAYER
#undef IN
#undef SEAM
}

extern "C" void kernel_launch(void* const* d_in, const int* in_sizes, int n_in, void* d_out, int out_size, void* d_ws, size_t ws_size, hipStream_t stream) {
    static int grid = 0;
    if (grid == 0) {
        if (n_in != 28 || out_size != NLAT * D || ws_size < WS_END) { fprintf(stderr, "kernel_launch: unexpected shapes (n_in %d, out %d, ws %zu < %zu)\n", n_in, out_size, ws_size, (size_t)WS_END); grid = -1; return; }
        int dev = 0, cus = 0, per_cu = 0;
        if (hipGetDevice(&dev) != hipSuccess || hipDeviceGetAttribute(&cus, hipDeviceAttributeMultiprocessorCount, dev) != hipSuccess) { grid = -1; return; }
        if (hipFuncSetAttribute((const void*)mk_fwd, hipFuncAttributeMaxDynamicSharedMemorySize, LDS_BYTES) != hipSuccess) { fprintf(stderr, "kernel_launch: hipFuncSetAttribute failed\n"); grid = -1; return; }
        if (hipOccupancyMaxActiveBlocksPerMultiprocessor(&per_cu, (const void*)mk_fwd, NTHREADS, LDS_BYTES) != hipSuccess || per_cu < 1) { fprintf(stderr, "kernel_launch: occupancy query says %d\n", per_cu); (void)hipGetLastError(); }
        grid = cus;
        if (grid < 32) { grid = -1; return; }
    }
    if (grid < 0) return;
    (void)hipMemsetAsync((char*)d_ws + WS_CTL, 0, CTL_BYTES, stream);
    Params p{};
    const float** pp = (const float**)&p;
    for (int i = 0; i < 28; ++i) pp[i] = (const float*)d_in[i];
    p.out = (float*)d_out; p.ws = (unsigned char*)d_ws;
#if MK_PER_PHASE
    for (int ph = 0; ph < NPHASE; ++ph) { p.ph_lo = ph; p.ph_hi = ph + 1; hipLaunchKernelGGL(mk_fwd, dim3(grid), dim3(NTHREADS), LDS_BYTES, stream, p); }
#else
    p.ph_lo = 0; p.ph_hi = NPHASE;
    hipLaunchKernelGGL(mk_fwd, dim3(grid), dim3(NTHREADS), LDS_BYTES, stream, p);
#endif
}
```
